# Optimizing an MI355X kernel written in HIP

```python
import jax, jax.numpy as jnp
from jax import lax
import numpy as np

D_MODEL = 2048
BATCH = 4
SEQ = 4096
DEPTH = 2

N_MEM = 256
EPS = 1e-6
CONV_WIDTH = D_MODEL // 2
CONV_K = 3
GLA_HEADS = 4
GLA_DK = D_MODEL // 2
GLA_DV = D_MODEL
GLA_RANK = 16
GLA_TAU = 16.0
GLA_CHUNK = 64
MEM_HEADS = 4
MEM_WIDTH = D_MODEL // 2
N_BRANCH = 3
N_GROUPS = 4
EXPERTS_PER_GROUP = 4
N_EXPERTS = N_GROUPS * EXPERTS_PER_GROUP
TOP_K = 2
D_EXPERT = D_MODEL // 4
IN_SPLITS = (CONV_WIDTH, CONV_WIDTH, CONV_WIDTH, GLA_DK, GLA_DK, GLA_DV, GLA_DV, GLA_RANK, MEM_WIDTH, D_MODEL, D_MODEL, D_MODEL)
D_IN = 3 * CONV_WIDTH + 2 * GLA_DK + 2 * GLA_DV + GLA_RANK + MEM_WIDTH + N_BRANCH * D_MODEL

kernel_name = "hybrid_gated_conv_gla_memxattn_hiermoe"


def rms_norm(x, g):
    xf = x.astype(jnp.float32)
    y = xf * lax.rsqrt(jnp.mean(xf * xf, axis=-1, keepdims=True) + EPS)
    return (y * g.astype(jnp.float32)).astype(x.dtype)


def split_columns(z):
    idx = np.cumsum(np.array(IN_SPLITS))[:-1].tolist()
    return jnp.split(z, idx, axis=-1)


def short_conv_mixer(gb, gc, v, w_conv):
    u = gc * v
    s = u.shape[1]
    y = w_conv[0] * u
    for k in range(1, CONV_K):
        y = y + w_conv[k] * jnp.pad(u, ((0, 0), (k, 0), (0, 0)))[:, :s]
    return gb * y


def gla_mixer(q, k, v, r, a_lr, w_a2, b_a2, g_norm):
    f32 = jnp.float32
    bsz, s, _ = q.shape
    H, C = GLA_HEADS, GLA_CHUNK
    dk, dv = GLA_DK // H, GLA_DV // H
    n = s // C
    log_a = jax.nn.log_sigmoid((a_lr @ w_a2 + b_a2).astype(f32)) / GLA_TAU

    def heads(t, d):
        return t.astype(f32).reshape(bsz, n, C, H, d).transpose(0, 3, 1, 2, 4)

    qh = heads(q, dk) * (dk ** -0.5)
    kh = heads(k, dk)
    vh = heads(v, dv)
    bcum = jnp.cumsum(heads(log_a, dk), axis=3)
    b_last = bcum[:, :, :, -1:]
    q_dec = qh * jnp.exp(bcum)
    k_dec = kh * jnp.exp(-bcum)
    k_to_end = kh * jnp.exp(b_last - bcum)
    mask = jnp.tril(jnp.ones((C, C), dtype=bool))
    att = jnp.where(mask, jnp.einsum('bhnid,bhnjd->bhnij', q_dec, k_dec), 0.0)
    o_intra = jnp.einsum('bhnij,bhnjv->bhniv', att, vh)

    def step(state, xs):
        qd, kd, vv, bl = xs
        o = jnp.einsum('bhcd,bhdv->bhcv', qd, state)
        state = jnp.exp(bl[:, :, 0, :])[..., None] * state + jnp.einsum('bhcd,bhcv->bhdv', kd, vv)
        return state, o

    xs = (jnp.moveaxis(q_dec, 2, 0), jnp.moveaxis(k_to_end, 2, 0), jnp.moveaxis(vh, 2, 0), jnp.moveaxis(b_last, 2, 0))
    s0 = jnp.zeros((bsz, H, dk, dv), f32)
    _, o_inter = lax.scan(step, s0, xs)
    o = o_intra + jnp.moveaxis(o_inter, 0, 2)
    o = o * lax.rsqrt(jnp.mean(o * o, axis=-1, keepdims=True) + EPS)
    o = o.transpose(0, 2, 3, 1, 4).reshape(bsz, s, GLA_DV) * g_norm.astype(f32)
    return (o * jax.nn.silu(r.astype(f32))).astype(q.dtype)


def memory_cross_attention(q, mem_n, w_mem_kv):
    bsz, s, _ = q.shape
    hd = MEM_WIDTH // MEM_HEADS
    kmem, vmem = jnp.split(mem_n @ w_mem_kv, 2, axis=-1)
    qh = q.reshape(bsz, s, MEM_HEADS, hd)
    kh = kmem.reshape(bsz, N_MEM, MEM_HEADS, hd)
    vh = vmem.reshape(bsz, N_MEM, MEM_HEADS, hd)
    sc = jnp.einsum('bshd,bmhd->bhsm', qh, kh).astype(jnp.float32) * (hd ** -0.5)
    p = jax.nn.softmax(sc, axis=-1).astype(q.dtype)
    return jnp.einsum('bhsm,bmhd->bshd', p, vh).reshape(bsz, s, MEM_WIDTH)


def hybrid_mixer(h, mem, w_in, conv_w, gla_w_a2, gla_b_a2, gla_norm, norm_mem, w_mem_kv,
                 w_br_conv, w_br_gla, w_br_mem, w_o):
    f32 = jnp.float32
    z = h @ w_in
    cb, cc, cv, gq, gk, gv, gr, ga, mq, gate_a, gate_b, gate_m = split_columns(z)
    y_a = short_conv_mixer(cb, cc, cv, conv_w)
    y_b = gla_mixer(gq, gk, gv, gr, ga, gla_w_a2, gla_b_a2, gla_norm)
    y_m = memory_cross_attention(mq, rms_norm(mem, norm_mem), w_mem_kv)
    merged = (jax.nn.sigmoid(gate_a.astype(f32)) * (y_a @ w_br_conv).astype(f32)
              + jax.nn.sigmoid(gate_b.astype(f32)) * (y_b @ w_br_gla).astype(f32)
              + jax.nn.sigmoid(gate_m.astype(f32)) * (y_m @ w_br_mem).astype(f32))
    return merged.astype(h.dtype) @ w_o


def hierarchical_moe(h, w_rg, w_re, w_gate, w_up, w_down):
    f32 = jnp.float32
    bsz, s, d = h.shape
    t = h.reshape(bsz * s, d)
    pg = jax.nn.softmax((t @ w_rg).astype(f32), axis=-1)
    gsel = jnp.argmax(pg, axis=-1)
    wg = jnp.take_along_axis(pg, gsel[:, None], axis=-1)
    le = (t @ w_re).astype(f32).reshape(-1, N_GROUPS, EXPERTS_PER_GROUP)
    le_sel = jnp.take_along_axis(le, gsel[:, None, None], axis=1)[:, 0]
    top_p, top_i = lax.top_k(jax.nn.softmax(le_sel, axis=-1), TOP_K)
    top_p = top_p / jnp.sum(top_p, axis=-1, keepdims=True)
    eid = gsel[:, None] * EXPERTS_PER_GROUP + top_i
    comb = jnp.sum(jax.nn.one_hot(eid, N_EXPERTS, dtype=f32) * (wg * top_p)[..., None], axis=1)
    out = jnp.zeros((bsz * s, d), f32)
    for e in range(N_EXPERTS):
        hid = jax.nn.silu(t @ w_gate[e]) * (t @ w_up[e])
        out = out + comb[:, e:e + 1] * (hid @ w_down[e]).astype(f32)
    return out.astype(h.dtype).reshape(bsz, s, d)


def _normal(key, shape, scale):
    return jax.random.normal(key, shape, jnp.float32) * scale


def setup_inputs(seed: int = 0) -> dict:
    key = jax.random.key(seed)
    ks = jax.random.split(key, 24)
    D = D_MODEL
    gain = lambda k, shape: 1.0 + _normal(k, shape, 0.02)
    return {
        "x": _normal(ks[0], (BATCH, SEQ, D), 1.0),
        "mem": _normal(ks[1], (BATCH, N_MEM, D), 1.0),
        "norm_mix": gain(ks[2], (DEPTH, D)),
        "w_in": _normal(ks[3], (DEPTH, D, D_IN), D ** -0.5),
        "conv_w": _normal(ks[4], (DEPTH, CONV_K, CONV_WIDTH), CONV_K ** -0.5),
        "gla_w_a2": _normal(ks[5], (DEPTH, GLA_RANK, GLA_DK), GLA_RANK ** -0.5),
        "gla_b_a2": _normal(ks[6], (DEPTH, GLA_DK), 0.1),
        "gla_norm": gain(ks[7], (DEPTH, GLA_DV)),
        "norm_mem": gain(ks[8], (DEPTH, D)),
        "w_mem_kv": _normal(ks[9], (DEPTH, D, 2 * MEM_WIDTH), D ** -0.5),
        "w_br_conv": _normal(ks[10], (DEPTH, CONV_WIDTH, D), CONV_WIDTH ** -0.5),
        "w_br_gla": _normal(ks[11], (DEPTH, GLA_DV, D), GLA_DV ** -0.5),
        "w_br_mem": _normal(ks[12], (DEPTH, MEM_WIDTH, D), MEM_WIDTH ** -0.5),
        "w_o": _normal(ks[13], (DEPTH, D, D), D ** -0.5),
        "norm_ffn": gain(ks[14], (DEPTH, D)),
        "w_router_group": _normal(ks[15], (DEPTH, D, N_GROUPS), D ** -0.5),
        "w_router_expert": _normal(ks[16], (DEPTH, D, N_EXPERTS), D ** -0.5),
        "w_gate": _normal(ks[17], (DEPTH, N_EXPERTS, D, D_EXPERT), D ** -0.5),
        "w_up": _normal(ks[18], (DEPTH, N_EXPERTS, D, D_EXPERT), D ** -0.5),
        "w_down": _normal(ks[19], (DEPTH, N_EXPERTS, D_EXPERT, D), D_EXPERT ** -0.5),
        "norm_final": gain(ks[20], (D,)),
    }


def reference(x, mem, norm_mix, w_in, conv_w, gla_w_a2, gla_b_a2, gla_norm, norm_mem, w_mem_kv,
              w_br_conv, w_br_gla, w_br_mem, w_o, norm_ffn, w_router_group, w_router_expert,
              w_gate, w_up, w_down, norm_final):
    for l in range(DEPTH):
        h = rms_norm(x, norm_mix[l])
        x = x + hybrid_mixer(h, mem, w_in[l], conv_w[l], gla_w_a2[l], gla_b_a2[l], gla_norm[l],
                             norm_mem[l], w_mem_kv[l], w_br_conv[l], w_br_gla[l], w_br_mem[l], w_o[l])
        h = rms_norm(x, norm_ffn[l])
        x = x + hierarchical_moe(h, w_router_group[l], w_router_expert[l], w_gate[l], w_up[l], w_down[l])
    return rms_norm(x, norm_final)
```

```cpp
#include <hip/hip_runtime.h>
#include <cstdio>
#include <cstdint>

#define GAS __attribute__((address_space(1)))
#define LAS __attribute__((address_space(3)))
typedef unsigned short bf16;
typedef short bf16x8 __attribute__((ext_vector_type(8)));
typedef float f32x2 __attribute__((ext_vector_type(2)));
typedef float f32x4 __attribute__((ext_vector_type(4)));
typedef float f32x16 __attribute__((ext_vector_type(16)));
typedef unsigned u32x2 __attribute__((ext_vector_type(2)));
typedef unsigned u32x4 __attribute__((ext_vector_type(4)));
typedef __bf16 bf16v2 __attribute__((ext_vector_type(2)));

#ifndef MK_PER_PHASE
#define MK_PER_PHASE 0
#endif

constexpr int NTOK = 16384, DM = 2048, SEQ = 4096, NBATCH = 4, NMEM = 256, DEPTH = 2;
constexpr int D_IN = 16400;
constexpr int LDZ = 16384;
constexpr int ZC_YA = 0, ZC_YB = 1024, ZC_YM = 3072, ZC_CC = 4096, ZC_CV = 5120, ZC_GQ = 6144, ZC_GK = 7168, ZC_GV = 8192, ZC_GATE_A = 10240, ZC_GATE_B = 12288, ZC_GATE_M = 14336;
constexpr float EPS = 1e-6f;
constexpr int NBUCKET = 24, LIST_CAP = 16384;

constexpr size_t MiB = 1u << 20;
constexpr size_t WS_CTL = 0, CTL_ZERO_BYTES = 1 * MiB;
constexpr size_t WS_Z = 2 * MiB;
constexpr size_t WS_H = 514 * MiB;
constexpr size_t WS_WIN = 578 * MiB;
constexpr size_t WS_WBR = 642 * MiB;
constexpr size_t WS_WO = 658 * MiB;
constexpr size_t WS_WGU = 666 * MiB;
constexpr size_t WS_WD = 730 * MiB;
constexpr size_t WS_WKV = 762 * MiB;
constexpr size_t WS_QD = 770 * MiB;
constexpr size_t WS_KT = 802 * MiB;
constexpr size_t WS_ATT = 834 * MiB;
constexpr size_t WS_ELAST = 842 * MiB;
constexpr size_t WS_GA = 843 * MiB;
constexpr size_t WS_SSQ = 844 * MiB;
constexpr size_t WS_KMEM = 848 * MiB;
constexpr size_t WS_VT = 850 * MiB;
constexpr size_t WS_MEMN = 852 * MiB;
constexpr size_t WS_LIST = 856 * MiB;
constexpr size_t WS_COMB = 858 * MiB;
constexpr size_t WS_MERGED = 859 * MiB;
constexpr size_t WS_END = 987 * MiB;
constexpr size_t WS_HID = WS_Z;
constexpr int CW_BAR = 4096;
constexpr int CW_CNT = 16384;

constexpr int RING_BYTES = 131072;
constexpr int MISC_OFF = RING_BYTES;
constexpr int LDS_BYTES = 147456;
constexpr int NWAVES = 8, NTHREADS = 512;

__device__ __forceinline__ unsigned pk2(float lo, float hi) { f32x2 v = {lo, hi}; bf16v2 r = __builtin_convertvector(v, bf16v2); return __builtin_bit_cast(unsigned, r); }
__device__ __forceinline__ bf16 f2bf(float f) { return (bf16)(pk2(f, 0.f) & 0xffffu); }
__device__ __forceinline__ float bflo(unsigned w) { return __uint_as_float(w << 16); }
__device__ __forceinline__ float bfhi(unsigned w) { return __uint_as_float(w & 0xffff0000u); }
__device__ __forceinline__ float bf2f(bf16 b) { return __uint_as_float(((unsigned)b) << 16); }
__device__ __forceinline__ float wave_sum(float v) {
#pragma unroll
    for (int o = 1; o < 64; o <<= 1) v += __shfl_xor(v, o);
    return v;
}
__device__ __forceinline__ float sigmoidf_(float x) { return 1.f / (1.f + __expf(-x)); }
#define LDS_WAIT() asm volatile("s_waitcnt lgkmcnt(0)" ::: "memory")
#define VM_WAIT() asm volatile("s_waitcnt vmcnt(0)" ::: "memory")
#define LDS_BARRIER() do { asm volatile("s_waitcnt lgkmcnt(0)" ::: "memory"); __builtin_amdgcn_s_barrier(); asm volatile("" ::: "memory"); } while (0)

namespace pg8 {
constexpr int BM = 256, BK = 64, HALF = 128, HTB = HALF * BK * 2, STAGE_BYTES = 8 * HTB, NXCD = 8, WGM = 8;
__host__ __device__ __forceinline__ int lds_byte(int r, int c) { const int st = (r >> 4) * 2 + (c >> 5), rr = r & 15, cc = c & 31, ob = rr * 64 + cc * 2; return st * 1024 + (ob ^ (((ob >> 9) & 1) << 5)); }
__host__ __device__ __forceinline__ void stage_rc(int b, int& R, int& C) { const int st = b / 1024, sb = b % 1024, swz = sb ^ (((sb >> 9) & 1) << 5); R = (st >> 1) * 16 + swz / 64; C = (st & 1) * 32 + (swz % 64) / 2; }
__host__ __device__ __forceinline__ int perm32(int rho) { const int n = rho >> 4, i = rho & 15; return 8 * (i >> 2) + 4 * n + (i & 3); }

struct Unit { int pm, pn, x0, x1, x2, x3, x4; };

__device__ __forceinline__ bool static_next(int nM, int nN, int G, int c, int i, Unit& u) {
    const int nwg = nM * nN; const long L = (long)i * G + c; if (L >= nwg) return false;
    int wgid = (int)L; { const int q = nwg / NXCD, r = nwg % NXCD, xcd = wgid % NXCD, off = wgid / NXCD; wgid = (xcd < r ? xcd * (q + 1) : r * (q + 1) + (xcd - r) * q) + off; }
    const int nig = WGM * nN, gid = wgid / nig, fm = gid * WGM, gsz = (nM - fm) < WGM ? (nM - fm) : WGM;
    u.pm = fm + ((wgid % nig) % gsz); u.pn = (wgid % nig) / gsz; return true;
}
struct SchedStatic {
    static constexpr bool GATHER = false;
    const bf16* A; const bf16* Bt; int lda, ldb, nt; int nM, nN, G, c;
    __device__ __forceinline__ bool next(int i, Unit& u) const { u.x0 = u.x1 = u.x2 = u.x3 = u.x4 = 0; return static_next(nM, nN, G, c, i, u); }
    __device__ __forceinline__ const char* a_base(const Unit& u) const { return (const char*)(A + (size_t)u.pm * BM * lda); }
    __device__ __forceinline__ const char* b_base(const Unit& u) const { return (const char*)(Bt + (size_t)u.pn * BM * ldb); }
    __device__ __forceinline__ size_t b_koff(const Unit&, int t) const { return (size_t)t * (BK * 2); }
    __device__ __forceinline__ void gather(const Unit&, unsigned (&)[2][2]) const {}
};

template <class Epi, class Sched, bool ALIGN_EPI>
__device__ __forceinline__ void gemm_phase(LAS unsigned char* lds, const Sched& S, const Epi& E) {
    constexpr bool GA_ = Sched::GATHER;
    int tid_ = threadIdx.x; asm volatile("" : "+v"(tid_));
    const int tid = tid_, wid = __builtin_amdgcn_readfirstlane(tid >> 6), lane = tid & 63, wr = wid >> 2, wc = wid & 3, fr = lane & 15, fq = lane >> 4;
    const int nt = S.nt;
    unsigned vb[2], va[2], vac[2][2], van[2][2];
#pragma unroll
    for (int i = 0; i < 2; ++i) { int R, C; stage_rc(tid * 16 + i * 8192, R, C); const int Rb = Epi::PERM ? ((R & ~31) + perm32(R & 31)) : R;
        vb[i] = (unsigned)(Rb * S.ldb + C) * 2u; va[i] = (unsigned)(R * S.lda + C) * 2u;
        vac[0][i] = vac[1][i] = van[0][i] = van[1][i] = 0u; }
    const size_t hstepA = (size_t)HALF * S.lda * 2, hstepB = (size_t)HALF * S.ldb * 2;
    const unsigned ldsw = (unsigned)wid * 1024u;
    const int aoff = lds_byte(wr * 64 + fr, fq * 8), boff = lds_byte(wc * 32 + fr, fq * 8);
#define PG8_SA(b, h) (((b) * 2 + (h)) * HTB)
#define PG8_SB(b, h) ((4 + (b) * 2 + (h)) * HTB)
#define PG8_GLDS(gptr, ldsoff) __builtin_amdgcn_global_load_lds((const unsigned*)(gptr), (LAS unsigned*)(lds + (ldsoff) + ldsw), 16, 0, 0)
#define PG8_STAGE_B(b, h, gbase) do { const char* _g = (const char*)(gbase) + (h) * hstepB; PG8_GLDS(_g + vb[0], PG8_SB(b, h)); PG8_GLDS(_g + vb[1], PG8_SB(b, h) + 8192); } while (0)
#define PG8_STAGE_A(b, h, gbase, NXT) do { if constexpr (GA_) { const char* _g = (const char*)(gbase); const unsigned _o0 = (NXT) ? van[h][0] : vac[h][0], _o1 = (NXT) ? van[h][1] : vac[h][1]; \
            PG8_GLDS(_g + _o0, PG8_SA(b, h)); PG8_GLDS(_g + _o1, PG8_SA(b, h) + 8192); } \
        else { const char* _g = (const char*)(gbase) + (h) * hstepA; PG8_GLDS(_g + va[0], PG8_SA(b, h)); PG8_GLDS(_g + va[1], PG8_SA(b, h) + 8192); } } while (0)
#define PG8_LDA(dst, b, h) do { _Pragma("unroll") for (int m = 0; m < 4; ++m) _Pragma("unroll") for (int k = 0; k < 2; ++k) dst[m][k] = *(const LAS bf16x8*)(lds + PG8_SA(b, h) + aoff + m * 2048 + k * 1024); } while (0)
#define PG8_LDB(dst, b, h) do { _Pragma("unroll") for (int n = 0; n < 2; ++n) _Pragma("unroll") for (int k = 0; k < 2; ++k) dst[n][k] = *(const LAS bf16x8*)(lds + PG8_SB(b, h) + boff + n * 2048 + k * 1024); } while (0)
#define PG8_MMA(ai, bj, At, Bt) do { __builtin_amdgcn_s_setprio(1); _Pragma("unroll") for (int m = 0; m < 4; ++m) _Pragma("unroll") for (int n = 0; n < 2; ++n) _Pragma("unroll") for (int k = 0; k < 2; ++k) \
        acc[ai][bj][m][n] = __builtin_amdgcn_mfma_f32_16x16x32_bf16(Bt[n][k], At[m][k], acc[ai][bj][m][n], 0, 0, 0); __builtin_amdgcn_s_setprio(0); } while (0)
#define PG8_WAIT_V(n) asm volatile("s_waitcnt vmcnt(" #n ")" ::: "memory")
#define PG8_WAIT_L(n) asm volatile("s_waitcnt lgkmcnt(" #n ")" ::: "memory")
#define PG8_BAR __builtin_amdgcn_s_barrier()
#define PG8_SCHED __builtin_amdgcn_sched_barrier(0)
    Unit cur, nxt; int ui = 0;
    if (!S.next(0, cur)) return;
    f32x4 acc[2][2][4][2];
#pragma unroll
    for (int a = 0; a < 2; ++a)
#pragma unroll
        for (int b = 0; b < 2; ++b)
#pragma unroll
            for (int m = 0; m < 4; ++m)
#pragma unroll
                for (int n = 0; n < 2; ++n) acc[a][b][m][n] = (f32x4){0.f, 0.f, 0.f, 0.f};
    bf16x8 At[4][2], B0[2][2], B1[2][2];
    const char* cA = S.a_base(cur); const char* cB = S.b_base(cur);
    asm volatile("" : "+s"(cA), "+s"(cB));
    if constexpr (GA_) S.gather(cur, vac);
    {
        const char* b0 = cB + S.b_koff(cur, 0); const char* b1 = cB + S.b_koff(cur, 1);
        PG8_STAGE_B(0, 0, b0); PG8_STAGE_B(0, 1, b0); PG8_STAGE_A(0, 0, cA, false); PG8_STAGE_A(0, 1, cA, false);
        if (wr == 1) PG8_BAR;
        PG8_WAIT_V(2); PG8_BAR;
        PG8_STAGE_B(1, 0, b1); PG8_STAGE_A(1, 0, cA + BK * 2, false); PG8_STAGE_B(1, 1, b1);
        PG8_WAIT_V(6); PG8_BAR;
    }
    for (;;) {
        const bool has_next = S.next(ui + 1, nxt);
        if (!has_next) nxt = cur;
        const char* nA = has_next ? S.a_base(nxt) : cA; const char* nB = has_next ? S.b_base(nxt) : cB;
        asm volatile("" : "+s"(nA), "+s"(nB));
        if constexpr (GA_) {
            if (has_next) S.gather(nxt, van);
            else {
#pragma unroll
                for (int h = 0; h < 2; ++h)
#pragma unroll
                    for (int i = 0; i < 2; ++i) van[h][i] = vac[h][i]; }
        }
        for (int t = 0; t < nt; t += 2) {
            const bool last = (t == nt - 2);
            const char* a1 = cA + (size_t)(t + 1) * (BK * 2);
            const char* a2 = last ? nA : cA + (size_t)(t + 2) * (BK * 2);
            const char* a3 = a2 + BK * 2;
            const char* b2 = last ? nB + S.b_koff(nxt, 0) : cB + S.b_koff(cur, t + 2);
            const char* b3 = last ? nB + S.b_koff(nxt, 1) : cB + S.b_koff(cur, t + 3);
            PG8_LDB(B0, 0, 0); PG8_LDB(B1, 0, 1); PG8_SCHED; PG8_LDA(At, 0, 0); PG8_STAGE_A(1, 1, a1, false);
            PG8_WAIT_V(8); PG8_WAIT_L(0); PG8_BAR; PG8_MMA(0, 0, At, B0); PG8_MMA(0, 1, At, B1); PG8_BAR; PG8_SCHED;
            PG8_LDA(At, 0, 1); PG8_STAGE_B(0, 0, b2); PG8_STAGE_B(0, 1, b2); PG8_STAGE_A(0, 0, a2, last);
            PG8_WAIT_V(8); PG8_WAIT_L(0); PG8_BAR; PG8_MMA(1, 0, At, B0); PG8_MMA(1, 1, At, B1); PG8_BAR; PG8_SCHED;
            PG8_LDB(B0, 1, 0); PG8_LDB(B1, 1, 1); PG8_SCHED; PG8_LDA(At, 1, 0); PG8_STAGE_A(0, 1, a2, last);
            PG8_WAIT_V(8); PG8_WAIT_L(0); PG8_BAR; PG8_MMA(0, 0, At, B0); PG8_MMA(0, 1, At, B1); PG8_BAR; PG8_SCHED;
            PG8_LDA(At, 1, 1); PG8_STAGE_B(1, 0, b3); PG8_STAGE_B(1, 1, b3); PG8_STAGE_A(1, 0, a3, last);
            PG8_WAIT_V(8); PG8_WAIT_L(0); PG8_BAR; PG8_MMA(1, 0, At, B0); PG8_MMA(1, 1, At, B1); PG8_BAR; PG8_SCHED;
        }
        if constexpr (ALIGN_EPI) { if (wr == 0) PG8_BAR; }
        if constexpr (!Epi::AFTER_DRAIN) { E(acc, cur, wr, wc, fr, fq); }
        if (!has_next) break;
#pragma unroll
        for (int a = 0; a < 2; ++a)
#pragma unroll
            for (int b = 0; b < 2; ++b)
#pragma unroll
                for (int m = 0; m < 4; ++m)
#pragma unroll
                    for (int n = 0; n < 2; ++n) acc[a][b][m][n] = (f32x4){0.f, 0.f, 0.f, 0.f};
        cur = nxt; cA = nA; cB = nB; ++ui;
        if constexpr (GA_) {
#pragma unroll
            for (int h = 0; h < 2; ++h)
#pragma unroll
                for (int i = 0; i < 2; ++i) vac[h][i] = van[h][i]; }
        if constexpr (ALIGN_EPI) { if (wr == 1) PG8_BAR; }
    }
    PG8_WAIT_V(0);
    if constexpr (!ALIGN_EPI) { if (wr == 0) PG8_BAR; }
    PG8_BAR;
    if constexpr (Epi::AFTER_DRAIN) { E.fused(acc, cur, wr, wc, fr, fq, lds, wid, lane); }
#undef PG8_SA
#undef PG8_SB
#undef PG8_GLDS
#undef PG8_STAGE_A
#undef PG8_STAGE_B
#undef PG8_LDA
#undef PG8_LDB
#undef PG8_MMA
#undef PG8_WAIT_V
#undef PG8_WAIT_L
#undef PG8_BAR
#undef PG8_SCHED
}
}
using pg8::Unit;

#define EPI_LOOP_ROWS for (int ai = 0; ai < 2; ++ai) _Pragma("unroll") for (int m = 0; m < 4; ++m)
struct EpiStoreBf16 {
    static constexpr bool PERM = true, AFTER_DRAIN = false;
    bf16* O; int ldc;
    __device__ __forceinline__ void operator()(const f32x4 (&acc)[2][2][4][2], const Unit& u, int wr, int wc, int fr, int fq) const {
        const int row0 = u.pm * 256 + wr * 64 + fr, col0 = u.pn * 256 + wc * 32 + 8 * fq;
#pragma unroll
        EPI_LOOP_ROWS { bf16* rowp = O + (size_t)(row0 + ai * 128 + m * 16) * ldc + col0;
#pragma unroll
            for (int bj = 0; bj < 2; ++bj) { const f32x4 v0 = acc[ai][bj][m][0], v1 = acc[ai][bj][m][1];
                u32x4 w; w.x = pk2(v0[0], v0[1]); w.y = pk2(v0[2], v0[3]); w.z = pk2(v1[0], v1[1]); w.w = pk2(v1[2], v1[3]);
                *(u32x4*)(rowp + bj * 128) = w; } }
    }
};
struct EpiKV {
    static constexpr bool PERM = true, AFTER_DRAIN = false;
    bf16* KM; bf16* VT;
    __device__ __forceinline__ void operator()(const f32x4 (&acc)[2][2][4][2], const Unit& u, int wr, int wc, int fr, int fq) const {
        const int r0 = wr * 64 + fr, c0 = wc * 32 + 8 * fq;
        if (u.pn < 4) {
#pragma unroll
            EPI_LOOP_ROWS { bf16* rowp = KM + (size_t)(u.pm * 256 + r0 + ai * 128 + m * 16) * 1024 + u.pn * 256 + c0;
#pragma unroll
                for (int bj = 0; bj < 2; ++bj) { const f32x4 v0 = acc[ai][bj][m][0], v1 = acc[ai][bj][m][1];
                    u32x4 w; w.x = pk2(v0[0], v0[1]); w.y = pk2(v0[2], v0[3]); w.z = pk2(v1[0], v1[1]); w.w = pk2(v1[2], v1[3]);
                    *(u32x4*)(rowp + bj * 128) = w; } }
        } else {
            bf16* base = VT + (size_t)(u.pm * 4 + (u.pn - 4)) * 65536 + r0;
#pragma unroll
            for (int bj = 0; bj < 2; ++bj)
#pragma unroll
                for (int n = 0; n < 2; ++n)
#pragma unroll
                    for (int e = 0; e < 4; ++e) { bf16* cp = base + (size_t)(c0 + bj * 128 + 4 * n + e) * 256; asm volatile("" : "+v"(cp));
#pragma unroll
                        EPI_LOOP_ROWS cp[ai * 128 + m * 16] = f2bf(acc[ai][bj][m][n][e]); }
        }
    }
};
template <int MODE> struct EpiBranch {
    static constexpr bool PERM = true, AFTER_DRAIN = false;
    const bf16* Zg; float* MG; bf16* H;
    __device__ __forceinline__ void operator()(const f32x4 (&acc)[2][2][4][2], const Unit& u, int wr, int wc, int fr, int fq) const {
        const int row0 = u.pm * 256 + wr * 64 + fr, col0 = u.pn * 256 + wc * 32 + 8 * fq;
#pragma unroll
        EPI_LOOP_ROWS { const size_t row = (size_t)(row0 + ai * 128 + m * 16);
#pragma unroll
            for (int bj = 0; bj < 2; ++bj) { const int col = col0 + bj * 128;
                const u32x4 g = *(const u32x4*)(Zg + row * LDZ + col);
                f32x4 s0, s1;
                s0[0] = sigmoidf_(bflo(g.x)); s0[1] = sigmoidf_(bfhi(g.x)); s0[2] = sigmoidf_(bflo(g.y)); s0[3] = sigmoidf_(bfhi(g.y));
                s1[0] = sigmoidf_(bflo(g.z)); s1[1] = sigmoidf_(bfhi(g.z)); s1[2] = sigmoidf_(bflo(g.w)); s1[3] = sigmoidf_(bfhi(g.w));
                f32x4 v0 = s0 * acc[ai][bj][m][0], v1 = s1 * acc[ai][bj][m][1];
                float* mp = MG + row * DM + col;
                if (MODE != 0) { v0 += *(const f32x4*)mp; v1 += *(const f32x4*)(mp + 4); }
                if (MODE != 2) { *(f32x4*)mp = v0; *(f32x4*)(mp + 4) = v1; }
                else { u32x4 w; w.x = pk2(v0[0], v0[1]); w.y = pk2(v0[2], v0[3]); w.z = pk2(v1[0], v1[1]); w.w = pk2(v1[2], v1[3]); *(u32x4*)(H + row * DM + col) = w; }
                asm volatile("" ::: "memory"); } }
    }
};
struct EpiResid {
    static constexpr bool PERM = true, AFTER_DRAIN = false;
    const float* xin; float* xout;
    __device__ __forceinline__ void operator()(const f32x4 (&acc)[2][2][4][2], const Unit& u, int wr, int wc, int fr, int fq) const {
        const int row0 = u.pm * 256 + wr * 64 + fr, col0 = u.pn * 256 + wc * 32 + 8 * fq;
#pragma unroll
        EPI_LOOP_ROWS { const size_t off = (size_t)(row0 + ai * 128 + m * 16) * DM + col0;
#pragma unroll
            for (int bj = 0; bj < 2; ++bj) { const f32x4 a = *(const f32x4*)(xin + off + bj * 128), b = *(const f32x4*)(xin + off + bj * 128 + 4);
                *(f32x4*)(xout + off + bj * 128) = a + acc[ai][bj][m][0]; *(f32x4*)(xout + off + bj * 128 + 4) = b + acc[ai][bj][m][1]; }
            asm volatile("" ::: "memory"); }
    }
};
struct EpiGU {
    static constexpr bool PERM = true, AFTER_DRAIN = false;
    bf16* HID; const int* LIST; const float* COMB;
    __device__ __forceinline__ void operator()(const f32x4 (&acc)[2][2][4][2], const Unit& u, int wr, int wc, int fr, int fq) const {
        const int r0 = wr * 64 + fr, c0 = u.x4 * 512 + u.pn * 128 + wc * 32 + 8 * fq;
#pragma unroll
        EPI_LOOP_ROWS { const int rl = r0 + ai * 128 + m * 16; int pos = u.x1 * 256 + rl; pos = pos < u.x2 ? pos : u.x2 - 1;
            const int tok = LIST[u.x0 * LIST_CAP + pos]; const float cw = COMB[tok * 2 + u.x4];
            const f32x4 g0 = acc[ai][0][m][0], g1 = acc[ai][0][m][1], u0 = acc[ai][1][m][0], u1 = acc[ai][1][m][1];
            float o[8];
#pragma unroll
            for (int e = 0; e < 4; ++e) { o[e] = g0[e] * sigmoidf_(g0[e]) * u0[e] * cw; o[4 + e] = g1[e] * sigmoidf_(g1[e]) * u1[e] * cw; }
            u32x4 w; w.x = pk2(o[0], o[1]); w.y = pk2(o[2], o[3]); w.z = pk2(o[4], o[5]); w.w = pk2(o[6], o[7]);
            *(u32x4*)(HID + (size_t)(u.pm * 256 + rl) * 1024 + c0) = w;
            asm volatile("" ::: "memory"); }
    }
};
struct EpiDown {
    static constexpr bool PERM = true, AFTER_DRAIN = false;
    float* X; const int* LIST;
    __device__ __forceinline__ void operator()(const f32x4 (&acc)[2][2][4][2], const Unit& u, int wr, int wc, int fr, int fq) const {
        const int r0 = wr * 64 + fr, col0 = u.pn * 256 + wc * 32 + 8 * fq;
#pragma unroll
        EPI_LOOP_ROWS { const int pos = u.x1 * 256 + r0 + ai * 128 + m * 16;
            if (pos < u.x2) { const int tok = LIST[u.x0 * LIST_CAP + pos]; float* xp = X + (size_t)tok * DM + col0;
#pragma unroll
                for (int bj = 0; bj < 2; ++bj) { const f32x4 a = *(const f32x4*)(xp + bj * 128), b = *(const f32x4*)(xp + bj * 128 + 4);
                    *(f32x4*)(xp + bj * 128) = a + acc[ai][bj][m][0]; *(f32x4*)(xp + bj * 128 + 4) = b + acc[ai][bj][m][1]; } }
            asm volatile("" ::: "memory"); }
    }
};
struct EpiSoftmax {
    static constexpr bool PERM = true, AFTER_DRAIN = true;
    bf16* O; int ldc;
    __device__ __forceinline__ void operator()(const f32x4 (&)[2][2][4][2], const Unit&, int, int, int, int) const {}
    __device__ __forceinline__ void fused(f32x4 (&acc)[2][2][4][2], const Unit& u, int wr, int wc, int fr, int fq, LAS unsigned char* lds, int, int) const {
        LAS float* T1 = (LAS float*)lds; LAS float* T2 = (LAS float*)(lds + 4096);
        const float sc = 0.0625f * 1.44269504089f;
#pragma unroll
        EPI_LOOP_ROWS { float mx = -3.0e38f;
#pragma unroll
            for (int bj = 0; bj < 2; ++bj)
#pragma unroll
                for (int n = 0; n < 2; ++n)
#pragma unroll
                    for (int e = 0; e < 4; ++e) mx = fmaxf(mx, acc[ai][bj][m][n][e]);
            mx = fmaxf(mx, __shfl_xor(mx, 16)); mx = fmaxf(mx, __shfl_xor(mx, 32));
            if (fq == 0) T1[(ai * 128 + wr * 64 + m * 16 + fr) * 4 + wc] = mx; }
        __syncthreads();
#pragma unroll
        EPI_LOOP_ROWS { const f32x4 t = *(const LAS f32x4*)(T1 + (ai * 128 + wr * 64 + m * 16 + fr) * 4);
            const float mx = fmaxf(fmaxf(t[0], t[1]), fmaxf(t[2], t[3])); float s = 0.f;
#pragma unroll
            for (int bj = 0; bj < 2; ++bj)
#pragma unroll
                for (int n = 0; n < 2; ++n)
#pragma unroll
                    for (int e = 0; e < 4; ++e) { const float p = __builtin_amdgcn_exp2f((acc[ai][bj][m][n][e] - mx) * sc); acc[ai][bj][m][n][e] = p; s += p; }
            s += __shfl_xor(s, 16); s += __shfl_xor(s, 32);
            if (fq == 0) T2[(ai * 128 + wr * 64 + m * 16 + fr) * 4 + wc] = s; }
        __syncthreads();
        const int row0 = u.pm * 256 + wr * 64 + fr, col0 = u.pn * 256 + wc * 32 + 8 * fq;
#pragma unroll
        EPI_LOOP_ROWS { const f32x4 t = *(const LAS f32x4*)(T2 + (ai * 128 + wr * 64 + m * 16 + fr) * 4);
            const float inv = 1.f / ((t[0] + t[1]) + (t[2] + t[3]));
            bf16* rowp = O + (size_t)(row0 + ai * 128 + m * 16) * ldc + col0;
#pragma unroll
            for (int bj = 0; bj < 2; ++bj) { const f32x4 v0 = acc[ai][bj][m][0] * inv, v1 = acc[ai][bj][m][1] * inv;
                u32x4 w; w.x = pk2(v0[0], v0[1]); w.y = pk2(v0[2], v0[3]); w.z = pk2(v1[0], v1[1]); w.w = pk2(v1[2], v1[3]);
                *(u32x4*)(rowp + bj * 128) = w; } }
    }
};

#define XB_TMO      128
#define XB_XCNT(j)  (256  + 64 * (j))
#define XB_XSUB(j)  (1280 + 64 * (j))
#define XB_XGEN(j)  (2304 + 64 * (j))
#define XB_TOP      3328
#define XB_TOPGEN   3392
#define XCD_BAR_WORDS 3456
#define XB_SPIN_CAP (1u << 18)
__device__ __forceinline__ unsigned xb_ld(unsigned* p)              { return __hip_atomic_load(p, __ATOMIC_RELAXED, __HIP_MEMORY_SCOPE_AGENT); }
__device__ __forceinline__ unsigned xb_add(unsigned* p, unsigned v) { return __hip_atomic_fetch_add(p, v, __ATOMIC_RELAXED, __HIP_MEMORY_SCOPE_AGENT); }
__device__ __forceinline__ unsigned xb_xcc_id() { return (unsigned)__builtin_amdgcn_s_getreg((3 << 11) | 20) & 0xFu; }
#define XB_SPIN(cond, bar) do { unsigned _sp = 0; while (cond) { __builtin_amdgcn_s_sleep(1); \
    if ((++_sp & 255u) == 0u) { if (xb_ld(&(bar)[XB_TMO])) break; if (_sp > XB_SPIN_CAP) { atomicAdd(&(bar)[XB_TMO], 1u); break; } } } } while (0)
struct XcdBarrier { unsigned* bar; unsigned x; volatile LAS unsigned* st; };
__device__ __forceinline__ XcdBarrier xcd_barrier_post(unsigned* bar, volatile LAS unsigned* st) {
    XcdBarrier b; b.bar = bar; b.x = xb_xcc_id(); b.st = st;
    if (threadIdx.x == 0) (void)xb_add(&bar[XB_XCNT(b.x)], 1u);
    return b;
}
__device__ __forceinline__ void xcd_barrier_complete(unsigned* bar, unsigned x, unsigned& nloc, unsigned& nx) {
    const unsigned G = gridDim.x * gridDim.y * gridDim.z;
    unsigned sum, cnt, mine, sp = 0u;
    for (;;) {
        sum = 0u; cnt = 0u; mine = 0u;
#pragma unroll
        for (unsigned j = 0; j < 16; ++j) { const unsigned c = xb_ld(&bar[XB_XCNT(j)]); sum += c; cnt += (c > 0u) ? 1u : 0u; mine = (j == x) ? c : mine; }
        if (sum == G) break;
        __builtin_amdgcn_s_sleep(1);
        if ((++sp & 255u) == 0u) { if (xb_ld(&bar[XB_TMO])) break; if (sp > XB_SPIN_CAP) { atomicAdd(&bar[XB_TMO], 1u); break; } }
    }
    nloc = mine > 0u ? mine : 1u; nx = cnt > 0u ? cnt : 1u;
}
__device__ __forceinline__ void xcd_barrier(const XcdBarrier& b) {
    asm volatile("s_waitcnt vmcnt(0)" ::: "memory");
    __syncthreads();
    if (threadIdx.x == 0) {
        unsigned* bar = b.bar;
        __builtin_amdgcn_s_waitcnt(0);
        unsigned nloc = b.st[0], nx = b.st[1];
        if (nloc == 0u) { xcd_barrier_complete(bar, b.x, nloc, nx); b.st[0] = nloc; b.st[1] = nx; }
        const unsigned old = xb_add(&bar[XB_XSUB(b.x)], 1u);
        const unsigned gen = old / nloc;
        if (old + 1u == (gen + 1u) * nloc) {
            __builtin_amdgcn_fence(__ATOMIC_RELEASE, "agent");
            asm volatile("s_waitcnt vmcnt(0)" ::: "memory");
            const unsigned og = xb_add(&bar[XB_TOP], 1u);
            const unsigned tg = og / nx;
            if (og + 1u == (tg + 1u) * nx) xb_add(&bar[XB_TOPGEN], 1u);
            else XB_SPIN(xb_ld(&bar[XB_TOPGEN]) == tg, bar);
            __builtin_amdgcn_fence(__ATOMIC_ACQUIRE, "agent");
            xb_add(&bar[XB_XGEN(b.x)], 1u);
            asm volatile("s_waitcnt vmcnt(0)" ::: "memory");
        } else {
            XB_SPIN(xb_ld(&bar[XB_XGEN(b.x)]) == gen, bar);
            __builtin_amdgcn_fence(__ATOMIC_ACQUIRE, "agent");
            asm volatile("s_waitcnt vmcnt(0)" ::: "memory");
        }
    }
    __syncthreads();
}

struct Frame {
    LAS unsigned char* lds;
    volatile LAS unsigned* MISC;
    unsigned* ctl;
    unsigned char* ws;
    int tid, lane, wave, G, bid;
    const float* const* in;
    float* out;
};

__device__ __forceinline__ Frame phase_frame(const Frame& F) {
    Frame P = F; int t = P.tid;
    asm volatile("" : "+s"(P.ws), "+s"(P.out), "+s"(P.ctl), "+s"(P.bid));
    asm volatile("" : "+v"(t));
    P.tid = t; P.lane = t & 63; P.wave = __builtin_amdgcn_readfirstlane(t >> 6);
    return P;
}
__device__ __forceinline__ void tr_item(const float* src, int srcN, int k0, int n0, bf16* dst, int dld, int drow0, int dk0, LAS float* scr, int lane) {
#pragma unroll 8
    for (int i = 0; i < 32; ++i) { const int kk = 2 * i + (lane >> 5); scr[kk * 33 + (lane & 31)] = src[(size_t)(k0 + kk) * srcN + n0 + (lane & 31)]; }
    LDS_WAIT(); asm volatile("" ::: "memory");
    const int c = lane & 7;
#pragma unroll
    for (int j = 0; j < 4; ++j) { const int n = (lane >> 3) + 8 * j; const LAS float* s = scr + (8 * c) * 33 + n;
        u32x4 o; o.x = pk2(s[0 * 33], s[1 * 33]); o.y = pk2(s[2 * 33], s[3 * 33]); o.z = pk2(s[4 * 33], s[5 * 33]); o.w = pk2(s[6 * 33], s[7 * 33]);
        *(u32x4*)(dst + (size_t)(drow0 + n) * dld + dk0 + 8 * c) = o; }
    LDS_WAIT(); asm volatile("" ::: "memory");
}
__device__ __forceinline__ int win_src_col(int n) { return n < 1024 ? n : (n < 3072 ? n + 6144 : (n < 4096 ? n + 6160 : (n < 10240 ? n - 3072 : n + 16))); }
__device__ __forceinline__ void rms_row_bf16(const float* xrow, const float* gain, bf16* orow, int lane) {
    f32x4 v[8]; float s = 0.f;
#pragma unroll
    for (int j = 0; j < 8; ++j) { v[j] = *(const f32x4*)(xrow + 256 * j + 4 * lane); s += (v[j][0] * v[j][0] + v[j][1] * v[j][1]) + (v[j][2] * v[j][2] + v[j][3] * v[j][3]); }
    const float rs = 1.f / sqrtf(wave_sum(s) * (1.f / DM) + EPS);
#pragma unroll
    for (int j = 0; j < 8; ++j) { const f32x4 g = *(const f32x4*)(gain + 256 * j + 4 * lane); const f32x4 y = v[j] * rs * g;
        u32x2 o; o.x = pk2(y[0], y[1]); o.y = pk2(y[2], y[3]); *(u32x2*)(orow + 256 * j + 4 * lane) = o; }
}
__device__ __forceinline__ void p_convert(Frame& F, int l) {
    LAS float* scr = (LAS float*)(F.lds + F.wave * 16384);
    const int gw = F.bid * NWAVES + F.wave, NGW = F.G * NWAVES;
    bf16* Win_t = (bf16*)(F.ws + WS_WIN); bf16* Wbr_t = (bf16*)(F.ws + WS_WBR); bf16* Wo_t = (bf16*)(F.ws + WS_WO);
    bf16* Wgu_t = (bf16*)(F.ws + WS_WGU); bf16* Wd_t = (bf16*)(F.ws + WS_WD); bf16* Wkv_t = (bf16*)(F.ws + WS_WKV);
    const float* w_in = F.in[3] + (size_t)l * DM * D_IN;
    const float* w_kv = F.in[9] + (size_t)l * DM * 2048;
    const float* w_bc = F.in[10] + (size_t)l * 1024 * DM;
    const float* w_bg = F.in[11] + (size_t)l * 2048 * DM;
    const float* w_bm = F.in[12] + (size_t)l * 1024 * DM;
    const float* w_o = F.in[13] + (size_t)l * DM * DM;
    const float* w_gate = F.in[17] + (size_t)l * 16 * DM * 512;
    const float* w_up = F.in[18] + (size_t)l * 16 * DM * 512;
    const float* w_down = F.in[19] + (size_t)l * 16 * 512 * DM;
    constexpr int I_IN = 16384, I_BR = 4096, I_O = 2048, I_GU = 16384, I_D = 8192, I_KV = 2048, NITEMS = I_IN + I_BR + I_O + I_GU + I_D + I_KV;
    for (int it = gw; it < NITEMS; it += NGW) {
        int r = it;
        if (r < I_IN) { const int kb = r >> 9, nb = r & 511; tr_item(w_in, D_IN, kb * 64, win_src_col(nb * 32), Win_t, 2048, nb * 32, kb * 64, scr, F.lane); continue; } r -= I_IN;
        if (r < I_BR) { const int kb = r >> 6, nb = r & 63, k = kb * 64; const float* src = k < 1024 ? w_bc : (k < 3072 ? w_bg : w_bm); const int k0 = k < 1024 ? k : (k < 3072 ? k - 1024 : k - 3072);
            tr_item(src, 2048, k0, nb * 32, Wbr_t, 4096, nb * 32, k, scr, F.lane); continue; } r -= I_BR;
        if (r < I_O) { const int kb = r >> 6, nb = r & 63; tr_item(w_o, 2048, kb * 64, nb * 32, Wo_t, 2048, nb * 32, kb * 64, scr, F.lane); continue; } r -= I_O;
        if (r < I_GU) { const int kb = r >> 9, nb = r & 511, e = nb >> 5, rem = nb & 31, q = rem >> 3, half = (rem >> 2) & 1, jb = rem & 3;
            const float* src = (half ? w_up : w_gate) + (size_t)e * DM * 512; tr_item(src, 512, kb * 64, q * 128 + jb * 32, Wgu_t, 2048, nb * 32, kb * 64, scr, F.lane); continue; } r -= I_GU;
        if (r < I_D) { const int e = r >> 9, rr = r & 511, kb = rr >> 6, nb = rr & 63; tr_item(w_down + (size_t)e * 512 * DM, 2048, kb * 64, nb * 32, Wd_t, 512, e * 2048 + nb * 32, kb * 64, scr, F.lane); continue; } r -= I_D;
        { const int kb = r >> 6, nb = r & 63; tr_item(w_kv, 2048, kb * 64, nb * 32, Wkv_t, 2048, nb * 32, kb * 64, scr, F.lane); }
    }
    const float* mem = F.in[1]; const float* nm = F.in[8] + (size_t)l * DM; bf16* MEMN = (bf16*)(F.ws + WS_MEMN);
    for (int m = gw; m < NBATCH * NMEM; m += NGW) rms_row_bf16(mem + (size_t)m * DM, nm, MEMN + (size_t)m * DM, F.lane);
}

template <int MODE>
__device__ __forceinline__ void norm_rows(Frame& F, const float* xin, const float* gain, const float* W16, int ldw, const float* Wg, bf16* hout, float* ga_out,
                                          unsigned* cnt, int* LIST, float* COMB, int gw, int NGW) {
    LAS f32x4* LW = (LAS f32x4*)F.lds;
    for (int e = F.tid; e < 8192; e += NTHREADS) { const int k = e >> 2, c4 = e & 3; const f32x4 v = *(const f32x4*)(W16 + (size_t)k * ldw + c4 * 4);
        const int pos = ((k >> 8) * 4 + (k & 3)) * 64 + ((k >> 2) & 63); LW[c4 * 2048 + pos] = v; }
    __syncthreads();
    const int lane = F.lane;
    f32x4 g[8];
#pragma unroll
    for (int j = 0; j < 8; ++j) g[j] = *(const f32x4*)(gain + 256 * j + 4 * lane);
    for (int row = gw; row < NTOK; row += NGW) {
        const float* xr = xin + (size_t)row * DM;
        f32x4 xv[8]; float ss = 0.f;
#pragma unroll
        for (int j = 0; j < 8; ++j) { xv[j] = *(const f32x4*)(xr + 256 * j + 4 * lane); ss += (xv[j][0] * xv[j][0] + xv[j][1] * xv[j][1]) + (xv[j][2] * xv[j][2] + xv[j][3] * xv[j][3]); }
        float acc[16]; float ag[4] = {0.f, 0.f, 0.f, 0.f};
#pragma unroll
        for (int c = 0; c < 16; ++c) acc[c] = 0.f;
#pragma unroll
        for (int j = 0; j < 8; ++j) { xv[j] = xv[j] * g[j];
#pragma unroll
            for (int e = 0; e < 4; ++e) { const float s = xv[j][e]; const int pos = (j * 4 + e) * 64 + lane;
#pragma unroll
                for (int c4 = 0; c4 < 4; ++c4) { const f32x4 w = LW[c4 * 2048 + pos]; acc[c4 * 4 + 0] += s * w[0]; acc[c4 * 4 + 1] += s * w[1]; acc[c4 * 4 + 2] += s * w[2]; acc[c4 * 4 + 3] += s * w[3]; }
                if (MODE == 1) { const f32x4 w = *(const f32x4*)(Wg + (size_t)(256 * j + 4 * lane + e) * 4); ag[0] += s * w[0]; ag[1] += s * w[1]; ag[2] += s * w[2]; ag[3] += s * w[3]; } }
            asm volatile("" ::: "memory"); }
        ss = wave_sum(ss);
#pragma unroll
        for (int c = 0; c < 16; ++c) acc[c] = wave_sum(acc[c]);
        const float rs = 1.f / sqrtf(ss * (1.f / DM) + EPS);
        bf16* hr = hout + (size_t)row * DM;
#pragma unroll
        for (int j = 0; j < 8; ++j) { const f32x4 y = xv[j] * rs; u32x2 o; o.x = pk2(y[0], y[1]); o.y = pk2(y[2], y[3]); *(u32x2*)(hr + 256 * j + 4 * lane) = o; }
        if (MODE == 0) {
            float v = 0.f;
#pragma unroll
            for (int c = 0; c < 16; ++c) v = (lane == c) ? acc[c] : v;
            if (lane < 16) ga_out[(size_t)row * 16 + lane] = v * rs;
        } else {
#pragma unroll
            for (int c = 0; c < 4; ++c) ag[c] = wave_sum(ag[c]) * rs;
            float best = ag[0]; int gs = 0;
#pragma unroll
            for (int c = 1; c < 4; ++c) if (ag[c] > best) { best = ag[c]; gs = c; }
            float den = 0.f;
#pragma unroll
            for (int c = 0; c < 4; ++c) den += __expf(ag[c] - best);
            const float wgt = 1.f / den;
            float le[4];
#pragma unroll
            for (int c = 0; c < 4; ++c) le[c] = (gs == 0 ? acc[c] : (gs == 1 ? acc[4 + c] : (gs == 2 ? acc[8 + c] : acc[12 + c]))) * rs;
            float l0 = le[0]; int i0 = 0;
#pragma unroll
            for (int c = 1; c < 4; ++c) if (le[c] > l0) { l0 = le[c]; i0 = c; }
            float l1 = -3.0e38f; int i1 = 0;
#pragma unroll
            for (int c = 0; c < 4; ++c) if (c != i0 && le[c] > l1) { l1 = le[c]; i1 = c; }
            const float p0 = 1.f / (1.f + __expf(l1 - l0)), p1 = 1.f - p0;
            const int lo = i0 < i1 ? i0 : i1, hi = i0 < i1 ? i1 : i0;
            const float c_lo = wgt * (i0 < i1 ? p0 : p1), c_hi = wgt * (i0 < i1 ? p1 : p0);
            const int pidx = lo == 0 ? hi - 1 : (lo == 1 ? hi + 1 : 5);
            const int bucket = gs * 6 + pidx;
            if (lane == 0) { const unsigned pos = atomicAdd(cnt + bucket, 1u); LIST[bucket * LIST_CAP + (int)pos] = row; COMB[row * 2] = c_lo; COMB[row * 2 + 1] = c_hi; }
        }
    }
}

__device__ __forceinline__ float logsigmoid_(float x) { return fminf(x, 0.f) - __logf(1.f + __expf(-fabsf(x))); }
__device__ __forceinline__ void p_gla_prep(Frame& F, int l) {
    constexpr int QP = 264;
    LAS bf16* Qs = (LAS bf16*)F.lds; LAS bf16* Ks = (LAS bf16*)(F.lds + 33792); LAS bf16* Es = (LAS bf16*)(F.lds + 67584);
    LAS float* GAs = (LAS float*)(F.lds + 101376); LAS bf16* As = (LAS bf16*)(F.lds + 105472);
    const bf16* Z = (const bf16*)(F.ws + WS_Z); const float* GA = (const float*)(F.ws + WS_GA);
    u32x4* QD = (u32x4*)(F.ws + WS_QD); u32x4* KT = (u32x4*)(F.ws + WS_KT); u32x4* AT = (u32x4*)(F.ws + WS_ATT); float* EL = (float*)(F.ws + WS_ELAST);
    const float* w_a2 = F.in[5] + (size_t)l * 16 * 1024; const float* b_a2 = F.in[6] + (size_t)l * 1024;
    const int tid = F.tid, lane = F.lane, w = F.wave, r = lane & 31, h = lane >> 5;
    for (int L = F.bid; L < 1024; L += F.G) {
        const int b = L >> 8, chunk = (L >> 2) & 63, head = L & 3, unit0 = (b * 4 + head) * 64 + chunk, row0 = b * SEQ + chunk * 64;
        if (tid < 256) *(LAS f32x4*)(GAs + tid * 4) = *(const f32x4*)(GA + (size_t)row0 * 16 + tid * 4);
        __syncthreads();
        {
            const int role = tid >> 8, d = tid & 255, col = head * 256 + d;
            float wv[16];
#pragma unroll
            for (int q = 0; q < 16; ++q) wv[q] = w_a2[q * 1024 + col];
            const float bb = b_a2[col];
            const bf16* zp = Z + (size_t)row0 * LDZ + (role == 0 ? ZC_GQ : ZC_GK) + col;
            float cs[64]; float c = 0.f;
#pragma unroll
            for (int t = 0; t < 64; ++t) { float s = bb;
#pragma unroll
                for (int q4 = 0; q4 < 4; ++q4) { const f32x4 gv = *(const LAS f32x4*)(GAs + t * 16 + q4 * 4); s += gv[0] * wv[q4 * 4] + gv[1] * wv[q4 * 4 + 1] + gv[2] * wv[q4 * 4 + 2] + gv[3] * wv[q4 * 4 + 3]; }
                c += logsigmoid_(s) * 0.0625f; cs[t] = c; }
            const bf16* zq = zp;
            if (role == 0) {
#pragma unroll
                for (int t = 0; t < 64; ++t) { const float q = bf2f(*zq); zq += LDZ; asm volatile("" : "+v"(zq)); Qs[t * QP + d] = f2bf(q * 0.0625f * __expf(cs[t])); }
            } else {
#pragma unroll
                for (int t = 0; t < 64; ++t) { const float k = bf2f(*zq); zq += LDZ; asm volatile("" : "+v"(zq)); Ks[t * QP + d] = f2bf(k * __expf(-cs[t])); Es[t * QP + d] = f2bf(k * __expf(c - cs[t])); }
                EL[(size_t)unit0 * 256 + d] = __expf(c);
            }
        }
        __syncthreads();
        if (w < 4) {
            const int mb = w & 1, nb = w >> 1; f32x16 acc;
#pragma unroll
            for (int i = 0; i < 16; ++i) acc[i] = 0.f;
#pragma unroll
            for (int s = 0; s < 16; ++s) { const bf16x8 a = *(const LAS bf16x8*)(Qs + (32 * mb + r) * QP + 16 * s + 8 * h), bq = *(const LAS bf16x8*)(Ks + (32 * nb + r) * QP + 16 * s + 8 * h);
                acc = __builtin_amdgcn_mfma_f32_32x32x16_bf16(a, bq, acc, 0, 0, 0); }
#pragma unroll
            for (int i = 0; i < 16; ++i) { const int cr = 32 * mb + (i & 3) + 8 * (i >> 2) + 4 * h, cc = 32 * nb + r; As[cr * 72 + cc] = f2bf(cc <= cr ? acc[i] : 0.f); }
        } else {
#pragma unroll
            for (int i = 0; i < 8; ++i) { const int f = (w - 4) * 8 + i, wp = f >> 2, mb = (f >> 1) & 1, s = f & 1;
                const LAS bf16* p = Qs + (32 * mb + r) * QP + 32 * wp + 16 * s + 4 * h;
                const u32x2 lo = *(const LAS u32x2*)p, hi = *(const LAS u32x2*)(p + 8);
                u32x4 o; o.x = lo.x; o.y = lo.y; o.z = hi.x; o.w = hi.y; QD[((size_t)unit0 * 32 + f) * 64 + lane] = o; }
        }
        __syncthreads();
        {
            const int s = w >> 1, mb = w & 1; AT[((size_t)unit0 * 8 + w) * 64 + lane] = *(const LAS u32x4*)(As + (32 * mb + r) * 72 + 16 * s + 8 * h);
#pragma unroll
            for (int s2 = 0; s2 < 4; ++s2) { unsigned short e[8];
#pragma unroll
                for (int j = 0; j < 8; ++j) e[j] = Es[(16 * s2 + 8 * h + j) * QP + 32 * w + r];
                u32x4 o; o.x = e[0] | ((unsigned)e[1] << 16); o.y = e[2] | ((unsigned)e[3] << 16); o.z = e[4] | ((unsigned)e[5] << 16); o.w = e[6] | ((unsigned)e[7] << 16);
                KT[((size_t)unit0 * 32 + w * 4 + s2) * 64 + lane] = o; }
        }
        __syncthreads();
    }
}
__device__ __forceinline__ void p_conv(Frame& F, int l) {
    bf16* Z = (bf16*)(F.ws + WS_Z); const float* cw = F.in[4] + (size_t)l * 3 * 1024;
    for (int idx = F.bid * NTHREADS + F.tid; idx < NTOK * 128; idx += F.G * NTHREADS) {
        const int tok = idx >> 7, c8 = (idx & 127) * 8, t = tok & (SEQ - 1);
        bf16* zr = Z + (size_t)tok * LDZ;
        const u32x4 vb = *(const u32x4*)(zr + ZC_YA + c8);
        float u[3][8];
#pragma unroll
        for (int k = 0; k < 3; ++k) {
            if (t >= k) { const u32x4 a = *(const u32x4*)(zr - (size_t)k * LDZ + ZC_CC + c8), bq = *(const u32x4*)(zr - (size_t)k * LDZ + ZC_CV + c8);
                u[k][0] = bflo(a.x) * bflo(bq.x); u[k][1] = bfhi(a.x) * bfhi(bq.x); u[k][2] = bflo(a.y) * bflo(bq.y); u[k][3] = bfhi(a.y) * bfhi(bq.y);
                u[k][4] = bflo(a.z) * bflo(bq.z); u[k][5] = bfhi(a.z) * bfhi(bq.z); u[k][6] = bflo(a.w) * bflo(bq.w); u[k][7] = bfhi(a.w) * bfhi(bq.w);
            } else {
#pragma unroll
                for (int e = 0; e < 8; ++e) u[k][e] = 0.f; }
        }
        float y[8];
#pragma unroll
        for (int e = 0; e < 8; ++e) y[e] = 0.f;
#pragma unroll
        for (int k = 0; k < 3; ++k) { const f32x4 w0 = *(const f32x4*)(cw + k * 1024 + c8), w1 = *(const f32x4*)(cw + k * 1024 + c8 + 4);
#pragma unroll
            for (int e = 0; e < 4; ++e) { y[e] += w0[e] * u[k][e]; y[4 + e] += w1[e] * u[k][4 + e]; } }
        u32x4 o; o.x = pk2(bflo(vb.x) * y[0], bfhi(vb.x) * y[1]); o.y = pk2(bflo(vb.y) * y[2], bfhi(vb.y) * y[3]); o.z = pk2(bflo(vb.z) * y[4], bfhi(vb.z) * y[5]); o.w = pk2(bflo(vb.w) * y[6], bfhi(vb.w) * y[7]);
        *(u32x4*)(zr + ZC_YA + c8) = o;
    }
}

__device__ __forceinline__ void p_gla_scan(Frame& F) {
    if (F.bid >= 256) return;
    const int xcd = F.bid & 7, idx = F.bid >> 3, bh = xcd * 2 + (idx >> 4), vs = idx & 15, b = bh >> 2, hh = bh & 3;
    const int w = F.wave, lane = F.lane, r = lane & 31, h = lane >> 5, tid = F.tid;
    LAS bf16* vT = (LAS bf16*)F.lds;
    LAS f32x4* P = (LAS f32x4*)(F.lds + 8192);
    const u32x4* QD = (const u32x4*)(F.ws + WS_QD) + (size_t)bh * 64 * 32 * 64;
    const u32x4* KT = (const u32x4*)(F.ws + WS_KT) + (size_t)bh * 64 * 32 * 64;
    const u32x4* AT = (const u32x4*)(F.ws + WS_ATT) + (size_t)bh * 64 * 8 * 64;
    const float* EL = (const float*)(F.ws + WS_ELAST) + (size_t)bh * 64 * 256;
    bf16* Zv = (bf16*)(F.ws + WS_Z) + (size_t)(b * SEQ) * LDZ + ZC_GV + hh * 512 + vs * 32;
    float* SS = (float*)(F.ws + WS_SSQ) + ((size_t)(b * SEQ) * 4 + hh) * 16 + vs;
    const int vrow = tid >> 3, vc4 = (tid & 7) * 4;
    f32x16 S;
#pragma unroll
    for (int i = 0; i < 16; ++i) S[i] = 0.f;
    u32x4 qf[4], kf[4], af[2]; f32x4 el[4]; u32x2 vv;
#define SCAN_LOAD(c, qf_, kf_, af_, el_, vv_) do { \
        _Pragma("unroll") for (int f = 0; f < 4; ++f) { qf_[f] = QD[((size_t)(c) * 32 + w * 4 + f) * 64 + lane]; kf_[f] = KT[((size_t)(c) * 32 + w * 4 + f) * 64 + lane]; } \
        _Pragma("unroll") for (int mb = 0; mb < 2; ++mb) af_[mb] = AT[((size_t)(c) * 8 + (w & 3) * 2 + mb) * 64 + lane]; \
        _Pragma("unroll") for (int i = 0; i < 4; ++i) el_[i] = *(const f32x4*)(EL + (size_t)(c) * 256 + 32 * w + 8 * i + 4 * h); \
        vv_ = *(const u32x2*)(Zv + (size_t)((c) * 64 + vrow) * LDZ + vc4); } while (0)
    SCAN_LOAD(0, qf, kf, af, el, vv);
    for (int c = 0; c < 64; ++c) {
        u32x4 qn[4], kn[4], an[2]; f32x4 eln[4]; u32x2 vn;
        const int cn = c + 1 < 64 ? c + 1 : c;
        SCAN_LOAD(cn, qn, kn, an, eln, vn);
        vT[(vc4 + 0) * 72 + vrow] = (bf16)(vv.x & 0xffffu); vT[(vc4 + 1) * 72 + vrow] = (bf16)(vv.x >> 16);
        vT[(vc4 + 2) * 72 + vrow] = (bf16)(vv.y & 0xffffu); vT[(vc4 + 3) * 72 + vrow] = (bf16)(vv.y >> 16);
        f32x16 o[2];
#pragma unroll
        for (int i = 0; i < 16; ++i) { o[0][i] = 0.f; o[1][i] = 0.f; }
#pragma unroll
        for (int s = 0; s < 2; ++s) { u32x4 sp; sp.x = pk2(S[8 * s + 0], S[8 * s + 1]); sp.y = pk2(S[8 * s + 2], S[8 * s + 3]); sp.z = pk2(S[8 * s + 4], S[8 * s + 5]); sp.w = pk2(S[8 * s + 6], S[8 * s + 7]);
            const bf16x8 sf = __builtin_bit_cast(bf16x8, sp);
#pragma unroll
            for (int mb = 0; mb < 2; ++mb) o[mb] = __builtin_amdgcn_mfma_f32_32x32x16_bf16(__builtin_bit_cast(bf16x8, qf[mb * 2 + s]), sf, o[mb], 0, 0, 0); }
        LDS_BARRIER();
        bf16x8 bfr[4];
#pragma unroll
        for (int s = 0; s < 4; ++s) bfr[s] = *(const LAS bf16x8*)(vT + r * 72 + 16 * s + 8 * h);
        if (w < 4) {
            const bf16x8 bw = *(const LAS bf16x8*)(vT + r * 72 + 16 * w + 8 * h);
#pragma unroll
            for (int mb = 0; mb < 2; ++mb) o[mb] = __builtin_amdgcn_mfma_f32_32x32x16_bf16(__builtin_bit_cast(bf16x8, af[mb]), bw, o[mb], 0, 0, 0);
        }
#pragma unroll
        for (int q = 0; q < 8; ++q) { f32x4 t; t[0] = o[q >> 2][4 * (q & 3) + 0]; t[1] = o[q >> 2][4 * (q & 3) + 1]; t[2] = o[q >> 2][4 * (q & 3) + 2]; t[3] = o[q >> 2][4 * (q & 3) + 3]; P[(w * 8 + q) * 64 + lane] = t; }
#pragma unroll
        for (int i = 0; i < 16; ++i) S[i] *= el[i >> 2][i & 3];
#pragma unroll
        for (int s = 0; s < 4; ++s) S = __builtin_amdgcn_mfma_f32_32x32x16_bf16(__builtin_bit_cast(bf16x8, kf[s]), bfr[s], S, 0, 0, 0);
        LDS_BARRIER();
        f32x4 t = {0.f, 0.f, 0.f, 0.f};
#pragma unroll
        for (int ww = 0; ww < 8; ++ww) t += P[(ww * 8 + w) * 64 + lane];
        const int tok0 = c * 64 + 32 * (w >> 2) + 8 * (w & 3) + 4 * h;
#pragma unroll
        for (int e = 0; e < 4; ++e) { Zv[(size_t)(tok0 + e) * LDZ + r] = f2bf(t[e]); float sq = t[e] * t[e];
#pragma unroll
            for (int o2 = 1; o2 < 32; o2 <<= 1) sq += __shfl_xor(sq, o2);
            if (r == 0) SS[(size_t)(tok0 + e) * 64] = sq; }
#pragma unroll
        for (int f = 0; f < 4; ++f) { qf[f] = qn[f]; kf[f] = kn[f]; el[f] = eln[f]; }
        af[0] = an[0]; af[1] = an[1]; vv = vn;
    }
#undef SCAN_LOAD
}
__device__ __forceinline__ void p_gla_post(Frame& F, int l) {
    bf16* Z = (bf16*)(F.ws + WS_Z); const float* SSQ = (const float*)(F.ws + WS_SSQ); const float* gn = F.in[7] + (size_t)l * 2048;
    for (int idx = F.bid * NTHREADS + F.tid; idx < NTOK * 256; idx += F.G * NTHREADS) {
        const int tok = idx >> 8, c8 = (idx & 255) * 8, head = c8 >> 9;
        const float* sp = SSQ + ((size_t)tok * 4 + head) * 16; float ss = 0.f;
#pragma unroll
        for (int q = 0; q < 4; ++q) { const f32x4 v = *(const f32x4*)(sp + q * 4); ss += (v[0] + v[1]) + (v[2] + v[3]); }
        const float rs = 1.f / sqrtf(ss * (1.f / 512.f) + EPS);
        bf16* zr = Z + (size_t)tok * LDZ;
        const u32x4 ov = *(const u32x4*)(zr + ZC_GV + c8), rv = *(const u32x4*)(zr + ZC_YB + c8);
        const f32x4 g0 = *(const f32x4*)(gn + c8), g1 = *(const f32x4*)(gn + c8 + 4);
        float o[8] = {bflo(ov.x), bfhi(ov.x), bflo(ov.y), bfhi(ov.y), bflo(ov.z), bfhi(ov.z), bflo(ov.w), bfhi(ov.w)};
        float rr[8] = {bflo(rv.x), bfhi(rv.x), bflo(rv.y), bfhi(rv.y), bflo(rv.z), bfhi(rv.z), bflo(rv.w), bfhi(rv.w)};
        float y[8];
#pragma unroll
        for (int e = 0; e < 8; ++e) y[e] = o[e] * rs * (e < 4 ? g0[e & 3] : g1[e & 3]) * (rr[e] * sigmoidf_(rr[e]));
        u32x4 w; w.x = pk2(y[0], y[1]); w.y = pk2(y[2], y[3]); w.z = pk2(y[4], y[5]); w.w = pk2(y[6], y[7]);
        *(u32x4*)(zr + ZC_YB + c8) = w;
    }
}

struct SchedOne {
    static constexpr bool GATHER = false;
    const bf16* A; const bf16* Bt; int lda, ldb, nt; bool active; int pm, pn;
    __device__ __forceinline__ bool next(int i, Unit& u) const { u.pm = pm; u.pn = pn; u.x0 = u.x1 = u.x2 = u.x3 = u.x4 = 0; return i == 0 && active; }
    __device__ __forceinline__ const char* a_base(const Unit&) const { return (const char*)A; }
    __device__ __forceinline__ const char* b_base(const Unit&) const { return (const char*)Bt; }
    __device__ __forceinline__ size_t b_koff(const Unit&, int t) const { return (size_t)t * 128; }
    __device__ __forceinline__ void gather(const Unit&, unsigned (&)[2][2]) const {}
};
template <bool DOWN> struct SchedMoE {
    static constexpr bool GATHER = !DOWN;
    const bf16* A; const bf16* Bt; int lda, ldb, nt; const int* LIST; volatile LAS unsigned* TB; int G, c;
    __device__ __forceinline__ int tb(int i) const { return __builtin_amdgcn_readfirstlane((int)TB[i]); }
    __device__ __forceinline__ bool next(int i, Unit& u) const {
        const int L = i * G + c, T = tb(24); if (L >= T * 8) return false;
        const int rt = L >> 3, j = L & 7; int k = 0;
        for (int q = 1; q < 24; ++q) k = (rt >= tb(q)) ? q : k;
        const int grp = k / 6, pi = k % 6, lo = pi < 3 ? 0 : (pi < 5 ? 1 : 2), hi = pi < 3 ? pi + 1 : (pi < 5 ? pi - 1 : 3);
        u.pm = rt; u.x0 = k; u.x1 = rt - tb(k); u.x2 = tb(32 + k);
        if (!DOWN) { u.pn = j & 3; u.x4 = j >> 2; u.x3 = grp * 4 + (u.x4 ? hi : lo); }
        else { u.pn = j; u.x3 = grp * 4 + lo; u.x4 = grp * 4 + hi; }
        return true;
    }
    __device__ __forceinline__ const char* a_base(const Unit& u) const { return DOWN ? (const char*)(A + (size_t)u.pm * 256 * lda) : (const char*)A; }
    __device__ __forceinline__ const char* b_base(const Unit& u) const {
        return DOWN ? (const char*)(Bt + ((size_t)u.x3 * 2048 + u.pn * 256) * 512) : (const char*)(Bt + ((size_t)u.x3 * 1024 + u.pn * 256) * 2048); }
    __device__ __forceinline__ size_t b_koff(const Unit& u, int t) const {
        if (!DOWN) return (size_t)t * 128;
        return t < 8 ? (size_t)t * 128 : (size_t)(u.x4 - u.x3) * (2048 * 512 * 2) + (size_t)(t - 8) * 128; }
    __device__ __forceinline__ void gather(const Unit& u, unsigned (&va)[2][2]) const {
#pragma unroll
        for (int i = 0; i < 2; ++i) { int R, C; pg8::stage_rc((int)threadIdx.x * 16 + i * 8192, R, C);
#pragma unroll
            for (int h = 0; h < 2; ++h) { int pos = u.x1 * 256 + h * 128 + R; pos = pos < u.x2 ? pos : u.x2 - 1; const int tok = LIST[u.x0 * LIST_CAP + pos]; va[h][i] = (unsigned)(tok * lda + C) * 2u; } }
    }
};
__device__ __forceinline__ void moe_table(Frame& F, const unsigned* cnt) {
    volatile LAS unsigned* TB = F.MISC + 64;
    __syncthreads();
    if (F.tid == 0) { unsigned p = 0;
        for (int k = 0; k < 24; ++k) { const unsigned c = __hip_atomic_load(cnt + k, __ATOMIC_RELAXED, __HIP_MEMORY_SCOPE_AGENT); TB[k] = p; TB[32 + k] = c; p += (c + 255u) >> 8; }
        TB[24] = p; }
    __syncthreads();
}

struct Args { const float* in[21]; float* out; unsigned char* ws; int ph_lo, ph_hi; };
constexpr int NPH = 11, NPHASES = DEPTH * NPH + 1;

__global__ void __launch_bounds__(NTHREADS, 2) mk_fwd(Args args) {
    extern __shared__ __attribute__((aligned(16))) unsigned char lds[];
    Frame F0;
    F0.lds = (LAS unsigned char*)lds; F0.MISC = (volatile LAS unsigned*)(F0.lds + MISC_OFF);
    F0.tid = threadIdx.x; F0.lane = F0.tid & 63; F0.wave = __builtin_amdgcn_readfirstlane(F0.tid >> 6); F0.G = gridDim.x; F0.bid = blockIdx.x;
    F0.ws = args.ws; F0.ctl = (unsigned*)(args.ws + WS_CTL); F0.out = args.out;
    F0.in = args.in;
    for (int u = F0.tid; u < 256; u += NTHREADS) ((LAS unsigned*)(F0.lds + MISC_OFF))[u] = 0u;
    __syncthreads();
    XcdBarrier bar; bar.bar = F0.ctl + CW_BAR; bar.x = 0; bar.st = nullptr;
    if (!MK_PER_PHASE) bar = xcd_barrier_post(F0.ctl + CW_BAR, F0.MISC + 8);
    const int lo = args.ph_lo, hi = args.ph_hi;
#ifdef ONLY_PHASE
#define PH_ON(k) ((k) == ONLY_PHASE)
#else
#define PH_ON(k) 1
#endif
#define IN(k) (lo <= (k) && (k) < hi)
#define SEAM(k) do { if (IN((k) + 1)) xcd_barrier(bar); } while (0)

    for (int l = 0; l < DEPTH; ++l) {
        const int p0 = l * NPH;
        const float* xcur = l == 0 ? F0.in[0] : F0.out;
        if (PH_ON(0) && IN(p0 + 0)) { Frame F = phase_frame(F0); bf16* Z = (bf16*)(F.ws + WS_Z); bf16* H = (bf16*)(F.ws + WS_H); (void)Z; (void)H; p_convert(F, l); SEAM(p0 + 0); }
        if (PH_ON(1) && IN(p0 + 1)) { Frame F = phase_frame(F0); bf16* Z = (bf16*)(F.ws + WS_Z); bf16* H = (bf16*)(F.ws + WS_H); (void)Z; (void)H;
            if (F.bid < 32) {
                SchedOne S{(const bf16*)(F.ws + WS_MEMN) + (size_t)(F.bid >> 3) * 256 * DM, (const bf16*)(F.ws + WS_WKV) + (size_t)(F.bid & 7) * 256 * DM, DM, DM, 32, true, F.bid >> 3, F.bid & 7};
                EpiKV E{(bf16*)(F.ws + WS_KMEM), (bf16*)(F.ws + WS_VT)};
                pg8::gemm_phase<EpiKV, SchedOne, false>(F.lds, S, E);
            } else {
                norm_rows<0>(F, xcur, F.in[2] + (size_t)l * DM, F.in[3] + (size_t)l * DM * D_IN + 9216, D_IN, nullptr, H, (float*)(F.ws + WS_GA), nullptr, nullptr, nullptr,
                             (F.bid - 32) * NWAVES + F.wave, (F.G - 32) * NWAVES);
            }
            SEAM(p0 + 1);
        }
        if (PH_ON(2) && IN(p0 + 2)) { Frame F = phase_frame(F0); bf16* Z = (bf16*)(F.ws + WS_Z); bf16* H = (bf16*)(F.ws + WS_H); (void)Z; (void)H;
            pg8::SchedStatic S{H, (const bf16*)(F.ws + WS_WIN), DM, DM, 32, 64, 64, F.G, F.bid};
            EpiStoreBf16 E{Z, LDZ};
            pg8::gemm_phase<EpiStoreBf16, pg8::SchedStatic, true>(F.lds, S, E);
            SEAM(p0 + 2);
        }
        if (PH_ON(3) && IN(p0 + 3)) { Frame F = phase_frame(F0); bf16* Z = (bf16*)(F.ws + WS_Z); bf16* H = (bf16*)(F.ws + WS_H); (void)Z; (void)H;
            p_gla_prep(F, l);
            p_conv(F, l);
            if (F.bid < 256) {
                const int b = F.bid >> 6, head = (F.bid >> 4) & 3, qt = F.bid & 15, pm = b * 16 + qt;
                const bf16* Aq = Z + (size_t)pm * 256 * LDZ + ZC_YM + head * 256;
                {
                    SchedOne S{Aq, (const bf16*)(F.ws + WS_KMEM) + (size_t)b * 256 * 1024 + head * 256, LDZ, 1024, 4, true, pm, head};
                    EpiSoftmax E{Z + ZC_YM, LDZ};
                    pg8::gemm_phase<EpiSoftmax, SchedOne, false>(F.lds, S, E);
                }
                VM_WAIT(); __syncthreads(); __builtin_amdgcn_fence(__ATOMIC_ACQUIRE, "agent"); VM_WAIT(); __syncthreads();
                {
                    SchedOne S{Aq, (const bf16*)(F.ws + WS_VT) + (size_t)(b * 4 + head) * 65536, LDZ, 256, 4, true, pm, head};
                    EpiStoreBf16 E{Z + ZC_YM, LDZ};
                    pg8::gemm_phase<EpiStoreBf16, SchedOne, false>(F.lds, S, E);
                }
            }
            SEAM(p0 + 3);
        }
        if (PH_ON(4) && IN(p0 + 4)) { Frame F = phase_frame(F0); bf16* Z = (bf16*)(F.ws + WS_Z); bf16* H = (bf16*)(F.ws + WS_H); (void)Z; (void)H; p_gla_scan(F); SEAM(p0 + 4); }
        if (PH_ON(5) && IN(p0 + 5)) { Frame F = phase_frame(F0); bf16* Z = (bf16*)(F.ws + WS_Z); bf16* H = (bf16*)(F.ws + WS_H); (void)Z; (void)H; p_gla_post(F, l); SEAM(p0 + 5); }
        if (PH_ON(6) && IN(p0 + 6)) { Frame F = phase_frame(F0); bf16* Z = (bf16*)(F.ws + WS_Z); bf16* H = (bf16*)(F.ws + WS_H); (void)Z; (void)H;
            const bf16* Wbr = (const bf16*)(F.ws + WS_WBR); float* MG = (float*)(F.ws + WS_MERGED);
            { pg8::SchedStatic S{Z + ZC_YA, Wbr, LDZ, 4096, 16, 64, 8, F.G, F.bid}; EpiBranch<0> E{Z + ZC_GATE_A, MG, H}; pg8::gemm_phase<EpiBranch<0>, pg8::SchedStatic, true>(F.lds, S, E); }
            { pg8::SchedStatic S{Z + ZC_YB, Wbr + 1024, LDZ, 4096, 32, 64, 8, F.G, F.bid}; EpiBranch<1> E{Z + ZC_GATE_B, MG, H}; pg8::gemm_phase<EpiBranch<1>, pg8::SchedStatic, true>(F.lds, S, E); }
            { pg8::SchedStatic S{Z + ZC_YM, Wbr + 3072, LDZ, 4096, 16, 64, 8, F.G, F.bid}; EpiBranch<2> E{Z + ZC_GATE_M, MG, H}; pg8::gemm_phase<EpiBranch<2>, pg8::SchedStatic, true>(F.lds, S, E); }
            SEAM(p0 + 6);
        }
        if (PH_ON(7) && IN(p0 + 7)) { Frame F = phase_frame(F0); bf16* Z = (bf16*)(F.ws + WS_Z); bf16* H = (bf16*)(F.ws + WS_H); (void)Z; (void)H;
            pg8::SchedStatic S{H, (const bf16*)(F.ws + WS_WO), DM, DM, 32, 64, 8, F.G, F.bid};
            EpiResid E{xcur, F.out};
            pg8::gemm_phase<EpiResid, pg8::SchedStatic, true>(F.lds, S, E);
            SEAM(p0 + 7);
        }
        if (PH_ON(8) && IN(p0 + 8)) { Frame F = phase_frame(F0); bf16* Z = (bf16*)(F.ws + WS_Z); bf16* H = (bf16*)(F.ws + WS_H); (void)Z; (void)H;
            norm_rows<1>(F, F.out, F.in[14] + (size_t)l * DM, F.in[16] + (size_t)l * DM * 16, 16, F.in[15] + (size_t)l * DM * 4, H, nullptr, F.ctl + CW_CNT + 64 * l,
                         (int*)(F.ws + WS_LIST), (float*)(F.ws + WS_COMB), F.bid * NWAVES + F.wave, F.G * NWAVES);
            SEAM(p0 + 8);
        }
        if (PH_ON(9) && IN(p0 + 9)) { Frame F = phase_frame(F0); bf16* Z = (bf16*)(F.ws + WS_Z); bf16* H = (bf16*)(F.ws + WS_H); (void)Z; (void)H;
            moe_table(F, F.ctl + CW_CNT + 64 * l);
            SchedMoE<false> S{H, (const bf16*)(F.ws + WS_WGU), DM, DM, 32, (const int*)(F.ws + WS_LIST), F.MISC + 64, F.G, F.bid};
            EpiGU E{(bf16*)(F.ws + WS_HID), (const int*)(F.ws + WS_LIST), (const float*)(F.ws + WS_COMB)};
            pg8::gemm_phase<EpiGU, SchedMoE<false>, true>(F.lds, S, E);
            SEAM(p0 + 9);
        }
        if (PH_ON(10) && IN(p0 + 10)) { Frame F = phase_frame(F0); bf16* Z = (bf16*)(F.ws + WS_Z); bf16* H = (bf16*)(F.ws + WS_H); (void)Z; (void)H;
            moe_table(F, F.ctl + CW_CNT + 64 * l);
            SchedMoE<true> S{(const bf16*)(F.ws + WS_HID), (const bf16*)(F.ws + WS_WD), 1024, 512, 16, (const int*)(F.ws + WS_LIST), F.MISC + 64, F.G, F.bid};
            EpiDown E{F.out, (const int*)(F.ws + WS_LIST)};
            pg8::gemm_phase<EpiDown, SchedMoE<true>, true>(F.lds, S, E);
            SEAM(p0 + 10);
        }
    }
    if (PH_ON(11) && IN(DEPTH * NPH)) { Frame F = phase_frame(F0); bf16* Z = (bf16*)(F.ws + WS_Z); bf16* H = (bf16*)(F.ws + WS_H); (void)Z; (void)H;
        const float* gf = F.in[20]; const int lane = F.lane;
        for (int row = F.bid * NWAVES + F.wave; row < NTOK; row += F.G * NWAVES) {
            float* xr = F.out + (size_t)row * DM; f32x4 v[8]; float s = 0.f;
#pragma unroll
            for (int j = 0; j < 8; ++j) { v[j] = *(const f32x4*)(xr + 256 * j + 4 * lane); s += (v[j][0] * v[j][0] + v[j][1] * v[j][1]) + (v[j][2] * v[j][2] + v[j][3] * v[j][3]); }
            const float rs = 1.f / sqrtf(wave_sum(s) * (1.f / DM) + EPS);
#pragma unroll
            for (int j = 0; j < 8; ++j) { const f32x4 g = *(const f32x4*)(gf + 256 * j + 4 * lane); *(f32x4*)(xr + 256 * j + 4 * lane) = v[j] * rs * g; }
        }
    }
#undef IN
#undef SEAM
}

extern "C" void kernel_launch(void* const* d_in, const int* in_sizes, int n_in, void* d_out, int out_size, void* d_ws, size_t ws_size, hipStream_t stream) {
    static int grid = 0;
    if (grid == 0) {
        if (n_in != 21 || out_size != NTOK * DM || ws_size < WS_END) { fprintf(stderr, "kernel_launch: unexpected shapes (n_in %d, out %d, ws %zu); nothing launched\n", n_in, out_size, ws_size); grid = -1; return; }
        int dev = 0, cus = 0, per_cu = 0;
        if (hipGetDevice(&dev) != hipSuccess || hipDeviceGetAttribute(&cus, hipDeviceAttributeMultiprocessorCount, dev) != hipSuccess) { grid = -1; return; }
        if (hipFuncSetAttribute((const void*)mk_fwd, hipFuncAttributeMaxDynamicSharedMemorySize, LDS_BYTES) != hipSuccess) { fprintf(stderr, "kernel_launch: hipFuncSetAttribute failed\n"); grid = -1; return; }
        if (hipOccupancyMaxActiveBlocksPerMultiprocessor(&per_cu, (const void*)mk_fwd, NTHREADS, LDS_BYTES) != hipSuccess || per_cu < 1) fprintf(stderr, "kernel_launch: note: occupancy query reports %d\n", per_cu);
        (void)hipGetLastError();
        grid = cus < 256 ? -1 : 256;
        if (grid < 0) { fprintf(stderr, "kernel_launch: needs 256 CUs, device has %d\n", cus); return; }
    }
    if (grid < 0) return;
    (void)hipMemsetAsync((char*)d_ws + WS_CTL, 0, CTL_ZERO_BYTES, stream);
    Args a{};
    for (int i = 0; i < 21; ++i) a.in[i] = (const float*)d_in[i];
    a.out = (float*)d_out; a.ws = (unsigned char*)d_ws;
#if MK_PER_PHASE
    for (int p = 0; p < NPHASES; ++p) { a.ph_lo = p; a.ph_hi = p + 1; hipLaunchKernelGGL(mk_fwd, dim3(grid), dim3(NTHREADS), LDS_BYTES, stream, a); }
#else
    a.ph_lo = 0; a.ph_hi = NPHASES;
    hipLaunchKernelGGL(mk_fwd, dim3(grid), dim3(NTHREADS), LDS_BYTES, stream, a);
#endif
    const hipError_t le = hipPeekAtLastError();
    if (le != hipSuccess) fprintf(stderr, "kernel_launch: launch failed: %s\n", hipGetErrorName(le));
}
```
